# Optimizing an MI355X kernel written in HIP

```python
import math
import jax, jax.numpy as jnp
from jax import lax
import numpy as np

D_MODEL = 1024
BATCH = 8
SEQ = 2048
DEPTH = 2

N_MIXERS = 2
N_MLA = (DEPTH + 1) // 2
N_SSM = DEPTH // 2
MLA_HEADS = 8
QK_NOPE = 128
QK_ROPE = 64
V_DIM = 128
Q_LORA = 256
KV_LORA = 128
ROPE_THETA = 10000.0
Q_BLOCK = 128
SSM_WIDTH = D_MODEL
GROUP_CH = 16
N_GROUPS = SSM_WIDTH // GROUP_CH
STATE = 64
DT_MIN = 0.001
DT_MAX = 0.1
D_FF = 4 * D_MODEL
ALPHA = (2 * DEPTH) ** 0.25
BETA = (8 * DEPTH) ** -0.25
LN_EPS = 1e-5
RMS_EPS = 1e-6

kernel_name = "hybrid_mla_s5_deepnorm_adaln"


def layer_norm(x, g, b):
    xf = x.astype(jnp.float32)
    mu = jnp.mean(xf, axis=-1, keepdims=True)
    var = jnp.mean(jnp.square(xf - mu), axis=-1, keepdims=True)
    y = (xf - mu) * lax.rsqrt(var + LN_EPS) * g.astype(jnp.float32) + b.astype(jnp.float32)
    return y.astype(x.dtype)


def rms_norm(x, g):
    xf = x.astype(jnp.float32)
    y = xf * lax.rsqrt(jnp.mean(jnp.square(xf), axis=-1, keepdims=True) + RMS_EPS) * g.astype(jnp.float32)
    return y.astype(x.dtype)


def rope_tables(positions):
    inv_freq = ROPE_THETA ** (-jnp.arange(0, QK_ROPE, 2, dtype=jnp.float32) / QK_ROPE)
    ang = positions.astype(jnp.float32)[..., None] * inv_freq
    return jnp.cos(ang), jnp.sin(ang)


def apply_rope(x, cos, sin):
    xf = x.astype(jnp.float32)
    x1, x2 = jnp.split(xf, 2, axis=-1)
    return jnp.concatenate([x1 * cos - x2 * sin, x1 * sin + x2 * cos], axis=-1).astype(x.dtype)


def mla_mixer(h, cos, sin, w_in, q_norm, w_qb, kv_norm, w_kvb, w_o):
    B, L, _ = h.shape
    z = h @ w_in
    cq = rms_norm(z[..., :Q_LORA], q_norm)
    ckv = rms_norm(z[..., Q_LORA:Q_LORA + KV_LORA], kv_norm)
    k_pe = apply_rope(z[..., Q_LORA + KV_LORA:], cos, sin)
    q = (cq @ w_qb).reshape(B, L, MLA_HEADS, QK_NOPE + QK_ROPE)
    q_nope = q[..., :QK_NOPE]
    q_pe = apply_rope(q[..., QK_NOPE:], cos[:, :, None, :], sin[:, :, None, :])
    kv = (ckv @ w_kvb).reshape(B, L, MLA_HEADS, QK_NOPE + V_DIM)
    k_nope = kv[..., :QK_NOPE]
    v = kv[..., QK_NOPE:]
    scale = 1.0 / math.sqrt(QK_NOPE + QK_ROPE)
    nb = L // Q_BLOCK
    qn_b = q_nope.reshape(B, nb, Q_BLOCK, MLA_HEADS, QK_NOPE).transpose(1, 0, 2, 3, 4)
    qp_b = q_pe.reshape(B, nb, Q_BLOCK, MLA_HEADS, QK_ROPE).transpose(1, 0, 2, 3, 4)
    k_idx = jnp.arange(L)

    def attend(args):
        qn, qp, start = args
        s = (jnp.einsum('bqhd,bkhd->bhqk', qn, k_nope)
             + jnp.einsum('bqhr,bkr->bhqk', qp, k_pe)).astype(jnp.float32) * scale
        q_idx = start + jnp.arange(Q_BLOCK)
        causal = k_idx[None, :] <= q_idx[:, None]
        s = jnp.where(causal, s, jnp.float32(-1e30))
        p = jax.nn.softmax(s, axis=-1).astype(v.dtype)
        return jnp.einsum('bhqk,bkhd->bqhd', p, v)

    o = lax.map(attend, (qn_b, qp_b, jnp.arange(nb) * Q_BLOCK))
    o = o.transpose(1, 0, 2, 3, 4).reshape(B, L, MLA_HEADS * V_DIM)
    return o @ w_o


def s5_mixer(h, w_in, log_dt, a_re, a_im, b_re, b_im, c_re, c_im, d_skip, w_glu, b_glu, w_out):
    B, L, _ = h.shape
    u = h @ w_in
    u32 = u.astype(jnp.float32).reshape(B, L, N_GROUPS, GROUP_CH)
    lr = a_re.astype(jnp.float32)
    li = a_im.astype(jnp.float32)
    dt = jnp.exp(log_dt.astype(jnp.float32))[:, None]
    mag = jnp.exp(lr * dt)
    ab_re = mag * jnp.cos(li * dt)
    ab_im = mag * jnp.sin(li * dt)
    den = lr * lr + li * li
    nr = ab_re - 1.0
    coef_re = ((nr * lr + ab_im * li) / den)[..., None]
    coef_im = ((ab_im * lr - nr * li) / den)[..., None]
    br = b_re.astype(jnp.float32)
    bi = b_im.astype(jnp.float32)
    bb_re = coef_re * br - coef_im * bi
    bb_im = coef_re * bi + coef_im * br
    bu_re = jnp.einsum('blgc,gpc->blgp', u32, bb_re)
    bu_im = jnp.einsum('blgc,gpc->blgp', u32, bb_im)
    a_re_t = jnp.broadcast_to(ab_re, (1, L, N_GROUPS, STATE))
    a_im_t = jnp.broadcast_to(ab_im, (1, L, N_GROUPS, STATE))

    def combine(e1, e2):
        a1r, a1i, b1r, b1i = e1
        a2r, a2i, b2r, b2i = e2
        return (a2r * a1r - a2i * a1i,
                a2r * a1i + a2i * a1r,
                a2r * b1r - a2i * b1i + b2r,
                a2r * b1i + a2i * b1r + b2i)

    _, _, xr, xi = lax.associative_scan(combine, (a_re_t, a_im_t, bu_re, bu_im), axis=1)
    y = (jnp.einsum('blgp,gcp->blgc', xr, c_re.astype(jnp.float32))
         - jnp.einsum('blgp,gcp->blgc', xi, c_im.astype(jnp.float32)))
    y = y + d_skip.astype(jnp.float32).reshape(N_GROUPS, GROUP_CH) * u32
    y = y.reshape(B, L, SSM_WIDTH).astype(h.dtype)
    g = jax.nn.gelu(y)
    z = g * jax.nn.sigmoid(g @ w_glu + b_glu)
    return z @ w_out


def sq_relu_mlp(h, w1, b1, w2, b2):
    a = jax.nn.relu(h @ w1 + b1)
    return (a * a) @ w2 + b2


def modulation(cs, w, b):
    m = cs @ w + b
    shift, scale, gate = jnp.split(m, 3, axis=-1)
    return shift[:, None, :], scale[:, None, :], gate[:, None, :]


def setup_inputs(seed: int = 0) -> dict:
    key = jax.random.key(seed)
    ks = iter(jax.random.split(key, 40))
    f32 = jnp.float32
    nrm = lambda shape, s: jax.random.normal(next(ks), shape, f32) * s
    D = D_MODEL
    x = jax.random.normal(next(ks), (BATCH, SEQ, D), f32)
    c = jax.random.normal(next(ks), (BATCH, D), f32)
    offs = jax.random.randint(next(ks), (BATCH, 1), 0, 1024, dtype=jnp.int32)
    positions = offs + jnp.arange(SEQ, dtype=jnp.int32)[None, :]
    mla_w_in = nrm((N_MLA, D, Q_LORA + KV_LORA + QK_ROPE), D ** -0.5)
    mla_q_norm = 1.0 + nrm((N_MLA, Q_LORA), 0.02)
    mla_w_qb = nrm((N_MLA, Q_LORA, MLA_HEADS * (QK_NOPE + QK_ROPE)), Q_LORA ** -0.5)
    mla_kv_norm = 1.0 + nrm((N_MLA, KV_LORA), 0.02)
    mla_w_kvb = nrm((N_MLA, KV_LORA, MLA_HEADS * (QK_NOPE + V_DIM)), KV_LORA ** -0.5)
    mla_w_o = nrm((N_MLA, MLA_HEADS * V_DIM, D), BETA * (MLA_HEADS * V_DIM) ** -0.5)
    ssm_w_in = nrm((N_SSM, D, SSM_WIDTH), D ** -0.5)
    ssm_log_dt = jax.random.uniform(next(ks), (N_SSM, N_GROUPS), f32,
                                    math.log(DT_MIN), math.log(DT_MAX))
    n_idx = jnp.arange(STATE, dtype=f32)
    ssm_a_re = -0.5 + nrm((N_SSM, N_GROUPS, STATE), 0.01)
    ssm_a_im = math.pi * n_idx + nrm((N_SSM, N_GROUPS, STATE), 0.01)
    ssm_b_re = nrm((N_SSM, N_GROUPS, STATE, GROUP_CH), (2 * GROUP_CH) ** -0.5)
    ssm_b_im = nrm((N_SSM, N_GROUPS, STATE, GROUP_CH), (2 * GROUP_CH) ** -0.5)
    ssm_c_re = nrm((N_SSM, N_GROUPS, GROUP_CH, STATE), (2 * STATE) ** -0.5)
    ssm_c_im = nrm((N_SSM, N_GROUPS, GROUP_CH, STATE), (2 * STATE) ** -0.5)
    ssm_d = nrm((N_SSM, SSM_WIDTH), 1.0)
    ssm_w_glu = nrm((N_SSM, SSM_WIDTH, SSM_WIDTH), SSM_WIDTH ** -0.5)
    ssm_b_glu = nrm((N_SSM, SSM_WIDTH), 0.01)
    ssm_w_out = nrm((N_SSM, SSM_WIDTH, D), BETA * SSM_WIDTH ** -0.5)
    mlp_w1 = nrm((DEPTH, D, D_FF), D ** -0.5)
    mlp_b1 = nrm((DEPTH, D_FF), 0.01)
    mlp_w2 = nrm((DEPTH, D_FF, D), BETA * D_FF ** -0.5)
    mlp_b2 = nrm((DEPTH, D), 0.01)
    mod_mix_w = nrm((DEPTH, D, 3 * D), 0.2 * D ** -0.5)
    mod_mix_b = nrm((DEPTH, 3 * D), 0.01)
    mod_ffn_w = nrm((DEPTH, D, 3 * D), 0.2 * D ** -0.5)
    mod_ffn_b = nrm((DEPTH, 3 * D), 0.01)
    ln_mix_g = 1.0 + nrm((DEPTH, D), 0.02)
    ln_mix_b = nrm((DEPTH, D), 0.01)
    ln_ffn_g = 1.0 + nrm((DEPTH, D), 0.02)
    ln_ffn_b = nrm((DEPTH, D), 0.01)
    return {"x": x, "c": c, "positions": positions,
            "mla_w_in": mla_w_in, "mla_q_norm": mla_q_norm, "mla_w_qb": mla_w_qb,
            "mla_kv_norm": mla_kv_norm, "mla_w_kvb": mla_w_kvb, "mla_w_o": mla_w_o,
            "ssm_w_in": ssm_w_in, "ssm_log_dt": ssm_log_dt, "ssm_a_re": ssm_a_re,
            "ssm_a_im": ssm_a_im, "ssm_b_re": ssm_b_re, "ssm_b_im": ssm_b_im,
            "ssm_c_re": ssm_c_re, "ssm_c_im": ssm_c_im, "ssm_d": ssm_d,
            "ssm_w_glu": ssm_w_glu, "ssm_b_glu": ssm_b_glu, "ssm_w_out": ssm_w_out,
            "mlp_w1": mlp_w1, "mlp_b1": mlp_b1, "mlp_w2": mlp_w2, "mlp_b2": mlp_b2,
            "mod_mix_w": mod_mix_w, "mod_mix_b": mod_mix_b,
            "mod_ffn_w": mod_ffn_w, "mod_ffn_b": mod_ffn_b,
            "ln_mix_g": ln_mix_g, "ln_mix_b": ln_mix_b,
            "ln_ffn_g": ln_ffn_g, "ln_ffn_b": ln_ffn_b}


def reference(x, c, positions,
              mla_w_in, mla_q_norm, mla_w_qb, mla_kv_norm, mla_w_kvb, mla_w_o,
              ssm_w_in, ssm_log_dt, ssm_a_re, ssm_a_im, ssm_b_re, ssm_b_im,
              ssm_c_re, ssm_c_im, ssm_d, ssm_w_glu, ssm_b_glu, ssm_w_out,
              mlp_w1, mlp_b1, mlp_w2, mlp_b2,
              mod_mix_w, mod_mix_b, mod_ffn_w, mod_ffn_b,
              ln_mix_g, ln_mix_b, ln_ffn_g, ln_ffn_b):
    cs = jax.nn.silu(c)
    cos, sin = rope_tables(positions)
    for i in range(DEPTH):
        shift, scale, gate = modulation(cs, mod_mix_w[i], mod_mix_b[i])
        h = x * (1.0 + scale) + shift
        j = i // N_MIXERS
        if i % N_MIXERS == 0:
            y = mla_mixer(h, cos, sin, mla_w_in[j], mla_q_norm[j], mla_w_qb[j],
                          mla_kv_norm[j], mla_w_kvb[j], mla_w_o[j])
        else:
            y = s5_mixer(h, ssm_w_in[j], ssm_log_dt[j], ssm_a_re[j], ssm_a_im[j],
                         ssm_b_re[j], ssm_b_im[j], ssm_c_re[j], ssm_c_im[j], ssm_d[j],
                         ssm_w_glu[j], ssm_b_glu[j], ssm_w_out[j])
        x = layer_norm(ALPHA * x + (1.0 + gate) * y, ln_mix_g[i], ln_mix_b[i])
        shift, scale, gate = modulation(cs, mod_ffn_w[i], mod_ffn_b[i])
        h = x * (1.0 + scale) + shift
        y = sq_relu_mlp(h, mlp_w1[i], mlp_b1[i], mlp_w2[i], mlp_b2[i])
        x = layer_norm(ALPHA * x + (1.0 + gate) * y, ln_ffn_g[i], ln_ffn_b[i])
    return x
```

```cpp
#include <hip/hip_runtime.h>
#include <hip/hip_cooperative_groups.h>
#include <cstdio>
#include <cstdint>
namespace cg = cooperative_groups;

#ifndef MK_PER_PHASE
#define MK_PER_PHASE 1
#endif
#ifndef MK_CG_SYNC
#define MK_CG_SYNC 0
#endif

#define LAS __attribute__((address_space(3)))
#define GAS __attribute__((address_space(1)))
typedef unsigned short bf16_t;
typedef short bf16x8 __attribute__((ext_vector_type(8)));
typedef float f32x4 __attribute__((ext_vector_type(4)));
typedef float f32x2 __attribute__((ext_vector_type(2)));
typedef float f32x16 __attribute__((ext_vector_type(16)));
typedef unsigned u32x4 __attribute__((ext_vector_type(4)));
typedef unsigned u32x2 __attribute__((ext_vector_type(2)));
typedef __bf16 bf16x2_t __attribute__((ext_vector_type(2)));

constexpr int BATCH = 8, SEQ = 2048, D = 1024, M = BATCH * SEQ, FF = 4096;
constexpr int NH = 8, QKN = 128, QKR = 64, DV = 128, QL = 256, KVL = 128, QHD = QKN + QKR;
constexpr int NG = 64, GC = 16, NS = 64, TCH = 16, NCH = SEQ / TCH;
constexpr float ALPHA = 1.4142135623730951f;
constexpr float LN_EPS = 1e-5f, RMS_EPS = 1e-6f;
constexpr float QSCALE = 0.07216878364870322f * 1.4426950408889634f;

constexpr size_t MiB = 1u << 20;
constexpr size_t WS_CTL = 0, CTL_ZERO_BYTES = 1 * MiB;
constexpr size_t CTL_MOD = 512 * 1024;
constexpr size_t WS_WIN = 1 * MiB;
constexpr size_t WS_WQB = 2 * MiB;
constexpr size_t WS_WKVB = 3 * MiB;
constexpr size_t WS_WO = 4 * MiB;
constexpr size_t WS_WSIN = 6 * MiB, WS_WGLU = 8 * MiB, WS_WSOUT = 10 * MiB;
constexpr size_t WS_W1 = 12 * MiB;
constexpr size_t WS_W2 = 28 * MiB;
constexpr size_t WS_BT1 = 44 * MiB;
constexpr size_t WS_BT2 = 52 * MiB;
constexpr size_t WS_ROPE = 64 * MiB;
constexpr size_t WS_APOW = 68 * MiB;
constexpr size_t WS_BB = 69 * MiB;
constexpr size_t WS_KMAT = 70 * MiB;
constexpr size_t WS_XN = 72 * MiB;
constexpr size_t WS_BIG = 104 * MiB;
constexpr size_t WS_CQ = WS_BIG, WS_CKV = WS_BIG + 8 * MiB, WS_KPE = WS_BIG + 12 * MiB, WS_Q = WS_BIG + 14 * MiB, WS_KN = WS_BIG + 62 * MiB, WS_VT = WS_BIG + 94 * MiB;
constexpr size_t WS_H = WS_BIG;
constexpr size_t WS_UGH = WS_BIG, WS_S = WS_BIG + 48 * MiB, WS_G = WS_BIG + 80 * MiB, WS_Z = WS_BIG + 112 * MiB;
constexpr size_t WS_END = 232 * MiB;
static_assert(WS_VT + 32 * MiB <= WS_END && WS_G + 32 * MiB <= WS_BIG + 112 * MiB, "ws map");

constexpr int LDS_BYTES = 147456;
constexpr int MISC_OFF = 131072 + 320;
constexpr int NWAVES = 8;

__device__ __forceinline__ unsigned cvtpk(float lo, float hi) { f32x2 v = {lo, hi}; bf16x2_t b = __builtin_convertvector(v, bf16x2_t); return __builtin_bit_cast(unsigned, b); }
__device__ __forceinline__ float bf2f(unsigned short u) { return __uint_as_float((unsigned)u << 16); }
__device__ __forceinline__ void st_bf4(bf16_t* p, f32x4 v) { u32x2 w; w.x = cvtpk(v.x, v.y); w.y = cvtpk(v.z, v.w); *(u32x2*)p = w; }
__device__ __forceinline__ f32x4 ld_bf4(const bf16_t* p) { u32x2 w = *(const u32x2*)p; f32x4 r; r.x = __uint_as_float(w.x << 16); r.y = __uint_as_float(w.x & 0xffff0000u); r.z = __uint_as_float(w.y << 16); r.w = __uint_as_float(w.y & 0xffff0000u); return r; }
__device__ __forceinline__ float wave_sum(float v) {
#pragma unroll
    for (int o = 1; o < 64; o <<= 1) v += __shfl_xor(v, o);
    return v;
}

namespace pg8 {
constexpr int BM = 256, BK = 64, HALF = 128, HTB = HALF * BK * 2, STAGE_BYTES = 8 * HTB, NXCD = 8, WGM = 8;
__host__ __device__ __forceinline__ int lds_byte(int r, int c) { const int st = (r >> 4) * 2 + (c >> 5), rr = r & 15, cc = c & 31, ob = rr * 64 + cc * 2; return st * 1024 + (ob ^ (((ob >> 9) & 1) << 5)); }
__host__ __device__ __forceinline__ void stage_rc(int b, int& R, int& C) { const int st = b / 1024, sb = b % 1024, swz = sb ^ (((sb >> 9) & 1) << 5); R = (st >> 1) * 16 + swz / 64; C = (st & 1) * 32 + (swz % 64) / 2; }

struct Unit { int pm, pn; };
struct Gemm { const bf16_t* A; const bf16_t* Bt; int K, lda, ldb; };

struct StaticOrder {
    int nM, nN, nwg, G, c;
    __device__ void init(int M_, int N_, int G_, int c_) { nM = M_ / BM; nN = N_ / BM; nwg = nM * nN; G = G_; c = c_; }
    __device__ bool next(int i, Unit& u) const {
        const long L = (long)i * G + c; if (L >= nwg) return false;
        int wgid = (int)L; { const int q = nwg / NXCD, r = nwg % NXCD, xcd = wgid % NXCD, off = wgid / NXCD; wgid = (xcd < r ? xcd * (q + 1) : r * (q + 1) + (xcd - r) * q) + off; }
        const int nig = WGM * nN, gid = wgid / nig, fm = gid * WGM, gsz = (nM - fm) < WGM ? (nM - fm) : WGM;
        u.pm = fm + ((wgid % nig) % gsz); u.pn = (wgid % nig) / gsz; return true;
    }
};
struct GroupOrder {
    int G, c;
    __device__ bool next(int i, Unit& u) const { const int L = i * G + c; if (L >= 256) return false; u.pm = L; u.pn = L >> 2; return true; }
};

template <class F> struct EpiEl {
    static constexpr bool AFTER_DRAIN = false; F f;
    __device__ __forceinline__ void operator()(const f32x4 (&acc)[2][2][4][2], const Unit& u, int wr, int wc, int fr, int fq) const {
#pragma unroll
        for (int ai = 0; ai < 2; ++ai)
#pragma unroll
            for (int m = 0; m < 4; ++m) { const int row = u.pm * BM + ai * HALF + wr * 64 + m * 16 + fr;
#pragma unroll
                for (int bj = 0; bj < 2; ++bj)
#pragma unroll
                    for (int n = 0; n < 2; ++n) f(row, u.pn, bj * HALF + wc * 32 + 16 * n + 4 * fq, acc[ai][bj][m][n]);
                __builtin_amdgcn_sched_barrier(0); }
    }
    __device__ __forceinline__ void fused(f32x4 (&)[2][2][4][2], const Unit&, int, int, int, int, LAS unsigned char*, int, int) const {}
};

struct EpiMlaIn {
    static constexpr bool AFTER_DRAIN = true;
    bf16_t* CQ; bf16_t* CKV; bf16_t* KPE; const float* qn; const float* kvn; const float* rope;
    __device__ __forceinline__ void operator()(const f32x4 (&)[2][2][4][2], const Unit&, int, int, int, int) const {}
    __device__ __forceinline__ void fused(f32x4 (&acc)[2][2][4][2], const Unit& u, int wr, int wc, int fr, int fq, LAS unsigned char* lds, int wid, int lane) const {
        LAS float* P = (LAS float*)lds;
        const bool t0 = (u.pn == 0);
#pragma unroll
        for (int ai = 0; ai < 2; ++ai)
#pragma unroll
            for (int m = 0; m < 4; ++m) { float s = 0.f;
#pragma unroll
                for (int bj = 0; bj < 2; ++bj) { if (bj == 1 && !t0) continue;
#pragma unroll
                    for (int n = 0; n < 2; ++n) { const f32x4 x = acc[ai][bj][m][n]; s += (x.x * x.x + x.y * x.y) + (x.z * x.z + x.w * x.w); } }
                s += __shfl_xor(s, 16); s += __shfl_xor(s, 32);
                if (fq == 0) P[(ai * HALF + wr * 64 + m * 16 + fr) * 4 + wc] = s; }
        __syncthreads();
#pragma unroll
        for (int ai = 0; ai < 2; ++ai)
#pragma unroll
            for (int m = 0; m < 4; ++m) { const int rl = ai * HALF + wr * 64 + m * 16 + fr; const size_t row = (size_t)u.pm * BM + rl;
                const f32x4 p4 = *(const LAS f32x4*)(P + rl * 4); const float ss = (p4.x + p4.y) + (p4.z + p4.w);
                if (t0) { const float rstd = 1.0f / sqrtf(ss * (1.0f / QL) + RMS_EPS);
#pragma unroll
                    for (int bj = 0; bj < 2; ++bj)
#pragma unroll
                        for (int n = 0; n < 2; ++n) { const int col = bj * HALF + wc * 32 + 16 * n + 4 * fq; const f32x4 g = *(const f32x4*)(qn + col); st_bf4(CQ + row * QL + col, acc[ai][bj][m][n] * rstd * g); }
                } else { const float rstd = 1.0f / sqrtf(ss * (1.0f / KVL) + RMS_EPS);
#pragma unroll
                    for (int n = 0; n < 2; ++n) { const int col = wc * 32 + 16 * n + 4 * fq; const f32x4 g = *(const f32x4*)(kvn + col); st_bf4(CKV + row * KVL + col, acc[ai][0][m][n] * rstd * g);
                        if (wc < 2) { const f32x4 v = acc[ai][1][m][n]; const f32x4 cs = *(const f32x4*)(rope + (row * 32 + (col >> 1)) * 2);
                            f32x4 o; o.x = v.x * cs.x - v.y * cs.y; o.y = v.x * cs.y + v.y * cs.x; o.z = v.z * cs.z - v.w * cs.w; o.w = v.z * cs.w + v.w * cs.z; st_bf4(KPE + row * QKR + col, o); } }
                } }
    }
};

template <class Epi, class Sched, bool ALIGN_EPI>
__device__ __forceinline__ void gemm_phase(LAS unsigned char* lds, const Gemm g, const Sched& S, const Epi& E) {
    int tid_ = threadIdx.x; asm volatile("" : "+v"(tid_));
    const int tid = tid_, wid = __builtin_amdgcn_readfirstlane(tid >> 6), lane = tid & 63, wr = wid >> 2, wc = wid & 3, fr = lane & 15, fq = lane >> 4;
    const int K = g.K, nt = K / BK;
    unsigned voffA[2], voffB[2];
#pragma unroll
    for (int i = 0; i < 2; ++i) { int R, C; stage_rc(tid * 16 + i * 8192, R, C); voffA[i] = (unsigned)(R * g.lda + C) * 2u; voffB[i] = (unsigned)(R * g.ldb + C) * 2u; }
    const size_t kstep = (size_t)(BK * 2);
    const size_t hstepA = (size_t)HALF * g.lda * 2, hstepB = (size_t)HALF * g.ldb * 2;
    const size_t tstepA = 2 * hstepA, tstepB = 2 * hstepB;
    const unsigned ldsw = (unsigned)wid * 1024u;
    const int aoff = lds_byte(wr * 64 + fr, fq * 8), boff = lds_byte(wc * 32 + fr, fq * 8);
#define PG8_SA(b, h) (((b) * 2 + (h)) * HTB)
#define PG8_SB(b, h) ((4 + (b) * 2 + (h)) * HTB)
#define PG8_STAGE(bufoff, gbase, voff) do { _Pragma("unroll") for (int _i = 0; _i < 2; ++_i) \
        __builtin_amdgcn_global_load_lds((const unsigned*)((const char*)(gbase) + (voff)[_i]), (LAS unsigned*)(lds + (bufoff) + ldsw + _i * 8192), 16, 0, 0); } while (0)
#define PG8_LDA(dst, b, h) do { _Pragma("unroll") for (int m = 0; m < 4; ++m) _Pragma("unroll") for (int k = 0; k < 2; ++k) dst[m][k] = *(const LAS bf16x8*)(lds + PG8_SA(b, h) + aoff + m * 2048 + k * 1024); } while (0)
#define PG8_LDB(dst, b, h) do { _Pragma("unroll") for (int n = 0; n < 2; ++n) _Pragma("unroll") for (int k = 0; k < 2; ++k) dst[n][k] = *(const LAS bf16x8*)(lds + PG8_SB(b, h) + boff + n * 2048 + k * 1024); } while (0)
#define PG8_MMA(ai, bj, At, Bt) do { __builtin_amdgcn_s_setprio(1); _Pragma("unroll") for (int m = 0; m < 4; ++m) _Pragma("unroll") for (int n = 0; n < 2; ++n) _Pragma("unroll") for (int k = 0; k < 2; ++k) \
        acc[ai][bj][m][n] = __builtin_amdgcn_mfma_f32_16x16x32_bf16(Bt[n][k], At[m][k], acc[ai][bj][m][n], 0, 0, 0); __builtin_amdgcn_s_setprio(0); } while (0)
#define PG8_WAIT_V(n) asm volatile("s_waitcnt vmcnt(" #n ")" ::: "memory")
#define PG8_WAIT_L(n) asm volatile("s_waitcnt lgkmcnt(" #n ")" ::: "memory")
#define PG8_BAR __builtin_amdgcn_s_barrier()
#define PG8_SCHED __builtin_amdgcn_sched_barrier(0)
    Unit cur, nxt; int ui = 0;
    if (!S.next(0, cur)) return;
    f32x4 acc[2][2][4][2];
#pragma unroll
    for (int a = 0; a < 2; ++a)
#pragma unroll
        for (int b = 0; b < 2; ++b)
#pragma unroll
            for (int m = 0; m < 4; ++m)
#pragma unroll
                for (int n = 0; n < 2; ++n) acc[a][b][m][n] = (f32x4){0.f, 0.f, 0.f, 0.f};
    bf16x8 At[4][2], B0[2][2], B1[2][2];
    const char* cA = (const char*)g.A + (size_t)cur.pm * tstepA; const char* cB = (const char*)g.Bt + (size_t)cur.pn * tstepB;
    PG8_STAGE(PG8_SB(0, 0), cB, voffB); PG8_STAGE(PG8_SB(0, 1), cB + hstepB, voffB); PG8_STAGE(PG8_SA(0, 0), cA, voffA); PG8_STAGE(PG8_SA(0, 1), cA + hstepA, voffA);
    if (wr == 1) PG8_BAR;
    PG8_WAIT_V(2); PG8_BAR;
    PG8_STAGE(PG8_SB(1, 0), cB + kstep, voffB); PG8_STAGE(PG8_SA(1, 0), cA + kstep, voffA); PG8_STAGE(PG8_SB(1, 1), cB + hstepB + kstep, voffB);
    PG8_WAIT_V(6); PG8_BAR;
    for (;;) {
        const bool has_next = S.next(ui + 1, nxt);
        const char* nA = has_next ? (const char*)g.A + (size_t)nxt.pm * tstepA : cA; const char* nB = has_next ? (const char*)g.Bt + (size_t)nxt.pn * tstepB : cB;
        for (int t = 0; t < nt; t += 2) {
            const bool last = (t == nt - 2);
            const char* a1 = cA + (size_t)(t + 1) * kstep;
            const char* a2 = last ? nA : cA + (size_t)(t + 2) * kstep; const char* b2 = last ? nB : cB + (size_t)(t + 2) * kstep;
            const char* a3 = a2 + kstep; const char* b3 = b2 + kstep;
            PG8_LDB(B0, 0, 0); PG8_LDB(B1, 0, 1); PG8_SCHED; PG8_LDA(At, 0, 0); PG8_STAGE(PG8_SA(1, 1), a1 + hstepA, voffA);
            PG8_WAIT_V(8); PG8_WAIT_L(0); PG8_BAR; PG8_MMA(0, 0, At, B0); PG8_MMA(0, 1, At, B1); PG8_BAR; PG8_SCHED;
            PG8_LDA(At, 0, 1); PG8_STAGE(PG8_SB(0, 0), b2, voffB); PG8_STAGE(PG8_SB(0, 1), b2 + hstepB, voffB); PG8_STAGE(PG8_SA(0, 0), a2, voffA);
            PG8_WAIT_V(8); PG8_WAIT_L(0); PG8_BAR; PG8_MMA(1, 0, At, B0); PG8_MMA(1, 1, At, B1); PG8_BAR; PG8_SCHED;
            PG8_LDB(B0, 1, 0); PG8_LDB(B1, 1, 1); PG8_SCHED; PG8_LDA(At, 1, 0); PG8_STAGE(PG8_SA(0, 1), a2 + hstepA, voffA);
            PG8_WAIT_V(8); PG8_WAIT_L(0); PG8_BAR; PG8_MMA(0, 0, At, B0); PG8_MMA(0, 1, At, B1); PG8_BAR; PG8_SCHED;
            PG8_LDA(At, 1, 1); PG8_STAGE(PG8_SB(1, 0), b3, voffB); PG8_STAGE(PG8_SB(1, 1), b3 + hstepB, voffB); PG8_STAGE(PG8_SA(1, 0), a3, voffA);
            PG8_WAIT_V(8); PG8_WAIT_L(0); PG8_BAR; PG8_MMA(1, 0, At, B0); PG8_MMA(1, 1, At, B1); PG8_BAR; PG8_SCHED;
        }
        if constexpr (ALIGN_EPI) { if (wr == 0) PG8_BAR; }
        if constexpr (!Epi::AFTER_DRAIN) { E(acc, cur, wr, wc, fr, fq); }
        if (!has_next) break;
#pragma unroll
        for (int a = 0; a < 2; ++a)
#pragma unroll
            for (int b = 0; b < 2; ++b)
#pragma unroll
                for (int m = 0; m < 4; ++m)
#pragma unroll
                    for (int n = 0; n < 2; ++n) acc[a][b][m][n] = (f32x4){0.f, 0.f, 0.f, 0.f};
        cur = nxt; cA = nA; cB = nB; ++ui;
        if constexpr (ALIGN_EPI) { if (wr == 1) PG8_BAR; }
    }
    PG8_WAIT_V(0);
    if constexpr (!ALIGN_EPI) { if (wr == 0) PG8_BAR; }
    PG8_BAR;
    if constexpr (Epi::AFTER_DRAIN) { E.fused(acc, cur, wr, wc, fr, fq, lds, wid, lane); }
#undef PG8_SA
#undef PG8_SB
#undef PG8_STAGE
#undef PG8_LDA
#undef PG8_LDB
#undef PG8_MMA
#undef PG8_WAIT_V
#undef PG8_WAIT_L
#undef PG8_BAR
#undef PG8_SCHED
}
}

struct FQ {
    bf16_t* Q; const float* rope;
    __device__ __forceinline__ void operator()(int row, int pn, int cin, f32x4 v) const {
        const int col = pn * 256 + cin; int c = (pn * 64) % QHD + cin; c = c >= QHD ? c - QHD : c; c = c >= QHD ? c - QHD : c;
        if (c >= QKN) { const f32x4 cs = *(const f32x4*)(rope + ((size_t)row * 32 + ((c - QKN) >> 1)) * 2);
            f32x4 o; o.x = v.x * cs.x - v.y * cs.y; o.y = v.x * cs.y + v.y * cs.x; o.z = v.z * cs.z - v.w * cs.w; o.w = v.z * cs.w + v.w * cs.z; v = o; }
        st_bf4(Q + (size_t)row * (NH * QHD) + col, v * QSCALE);
    }
};
struct FKV {
    bf16_t* KN; bf16_t* VT;
    __device__ __forceinline__ void operator()(int row, int pn, int cin, f32x4 v) const {
        const int h = pn, c = cin;
        if (c < QKN) st_bf4(KN + (size_t)row * (NH * QKN) + h * QKN + c, v);
        else { const int b = row >> 11, t = row & (SEQ - 1); bf16_t* p = VT + ((size_t)((b * NH + h) * DV + (c - QKN))) * SEQ + t;
            const unsigned w0 = cvtpk(v.x, v.y), w1 = cvtpk(v.z, v.w);
            p[0] = (bf16_t)(w0 & 0xffffu); p[SEQ] = (bf16_t)(w0 >> 16); p[2 * SEQ] = (bf16_t)(w1 & 0xffffu); p[3 * SEQ] = (bf16_t)(w1 >> 16); }
    }
};
struct FRes {
    const float* src; float* R; const float* gate; const float* bias;
    __device__ __forceinline__ void operator()(int row, int pn, int cin, f32x4 v) const {
        const int col = pn * 256 + cin; const int b = row >> 11; const f32x4 g = *(const f32x4*)(gate + b * 3 * D + col), s = *(const f32x4*)(src + (size_t)row * D + col);
        if (bias) v = v + *(const f32x4*)(bias + col);
        *(f32x4*)(R + (size_t)row * D + col) = s * ALPHA + (g + 1.0f) * v;
    }
};
struct FRelu2 {
    bf16_t* H; const float* b1;
    __device__ __forceinline__ void operator()(int row, int pn, int cin, f32x4 v) const {
        const int col = pn * 256 + cin; v = v + *(const f32x4*)(b1 + col); v.x = fmaxf(v.x, 0.f); v.y = fmaxf(v.y, 0.f); v.z = fmaxf(v.z, 0.f); v.w = fmaxf(v.w, 0.f);
        st_bf4(H + (size_t)row * FF + col, v * v);
    }
};
struct FU {
    bf16_t* UGH;
    __device__ __forceinline__ void operator()(int row, int pn, int cin, f32x4 v) const {
        const int col = pn * 256 + cin; const int b = row >> 11, t = row & (SEQ - 1), g = col >> 4, c = col & 15;
        st_bf4(UGH + ((size_t)((g * BATCH + b) * NCH + (t >> 4))) * 384 + (t & 15) * 16 + c, v);
    }
};
struct FS {
    float* S;
    __device__ __forceinline__ void operator()(int row, int pn, int cin, f32x4 v) const { const int n = cin; if (n < 128) *(f32x4*)(S + (size_t)row * 128 + n) = v; }
};
__device__ __forceinline__ float gelu_tanh(float x) {
    const float u = 0.7978845608028654f * (x + 0.044715f * x * x * x);
    const float e = __builtin_amdgcn_exp2f(-2.885390081777927f * u);
    return x * __builtin_amdgcn_rcpf(1.0f + e);
}
struct FG {
    bf16_t* G;
    __device__ __forceinline__ void operator()(int row, int pn, int cin, f32x4 v) const {
        const int g = row >> 10, b = (row >> 7) & 7, k = row & 127, cl = cin, t = cl >> 4, c = cl & 15;
        f32x4 o; o.x = gelu_tanh(v.x); o.y = gelu_tanh(v.y); o.z = gelu_tanh(v.z); o.w = gelu_tanh(v.w);
        st_bf4(G + ((size_t)(b * SEQ + k * 16 + t)) * D + g * 16 + c, o);
    }
};
struct FGlu {
    const bf16_t* G; bf16_t* Z; const float* bg;
    __device__ __forceinline__ void operator()(int row, int pn, int cin, f32x4 v) const {
        const int col = pn * 256 + cin; v = v + *(const f32x4*)(bg + col); const f32x4 g = ld_bf4(G + (size_t)row * D + col);
        f32x4 o; o.x = g.x * __builtin_amdgcn_rcpf(1.0f + __builtin_amdgcn_exp2f(-1.4426950408889634f * v.x)); o.y = g.y * __builtin_amdgcn_rcpf(1.0f + __builtin_amdgcn_exp2f(-1.4426950408889634f * v.y));
        o.z = g.z * __builtin_amdgcn_rcpf(1.0f + __builtin_amdgcn_exp2f(-1.4426950408889634f * v.z)); o.w = g.w * __builtin_amdgcn_rcpf(1.0f + __builtin_amdgcn_exp2f(-1.4426950408889634f * v.w));
        st_bf4(Z + (size_t)row * D + col, o);
    }
};

#define XB_TMO      128
#define XB_XCNT(j)  (256  + 64 * (j))
#define XB_XSUB(j)  (1280 + 64 * (j))
#define XB_XGEN(j)  (2304 + 64 * (j))
#define XB_TOP      3328
#define XB_TOPGEN   3392
#define XCD_BAR_WORDS 3456
#define XB_SPIN_CAP (1u << 22)
__device__ __forceinline__ unsigned xb_ld(unsigned* p)              { return __hip_atomic_load(p, __ATOMIC_RELAXED, __HIP_MEMORY_SCOPE_AGENT); }
__device__ __forceinline__ unsigned xb_add(unsigned* p, unsigned v) { return __hip_atomic_fetch_add(p, v, __ATOMIC_RELAXED, __HIP_MEMORY_SCOPE_AGENT); }
__device__ __forceinline__ unsigned xb_xcc_id() { return (unsigned)__builtin_amdgcn_s_getreg((3 << 11) | 20) & 0xFu; }
#define XB_SPIN(cond, bar) do { unsigned _sp = 0; while (cond) { __builtin_amdgcn_s_sleep(1); \
    if ((++_sp & 255u) == 0u) { if (xb_ld(&(bar)[XB_TMO])) break; if (_sp > XB_SPIN_CAP) { atomicAdd(&(bar)[XB_TMO], 1u); break; } } } } while (0)
struct XcdBarrier { unsigned* bar; unsigned x; volatile LAS unsigned* st; };
__device__ __forceinline__ XcdBarrier xcd_barrier_post(unsigned* bar, volatile LAS unsigned* st) {
    XcdBarrier b; b.bar = bar; b.x = xb_xcc_id(); b.st = st;
    if (threadIdx.x == 0) (void)xb_add(&bar[XB_XCNT(b.x)], 1u);
    return b;
}
__device__ __forceinline__ void xcd_barrier_complete(unsigned* bar, unsigned x, unsigned& nloc, unsigned& nx) {
    const unsigned G = gridDim.x * gridDim.y * gridDim.z;
    unsigned sum, cnt, mine, sp = 0u;
    for (;;) {
        sum = 0u; cnt = 0u; mine = 0u;
#pragma unroll
        for (unsigned j = 0; j < 16; ++j) { const unsigned c = xb_ld(&bar[XB_XCNT(j)]); sum += c; cnt += (c > 0u) ? 1u : 0u; mine = (j == x) ? c : mine; }
        if (sum == G) break;
        __builtin_amdgcn_s_sleep(1);
        if ((++sp & 255u) == 0u) { if (xb_ld(&bar[XB_TMO])) break; if (sp > XB_SPIN_CAP) { atomicAdd(&bar[XB_TMO], 1u); break; } }
    }
    nloc = mine > 0u ? mine : 1u; nx = cnt > 0u ? cnt : 1u;
}
__device__ __forceinline__ void xcd_barrier(const XcdBarrier& b) {
    asm volatile("s_waitcnt vmcnt(0)" ::: "memory");
    __syncthreads();
    if (threadIdx.x == 0) {
        unsigned* bar = b.bar;
        __builtin_amdgcn_s_waitcnt(0);
        unsigned nloc = b.st[0], nx = b.st[1];
        if (nloc == 0u) { xcd_barrier_complete(bar, b.x, nloc, nx); b.st[0] = nloc; b.st[1] = nx; }
        const unsigned old = xb_add(&bar[XB_XSUB(b.x)], 1u);
        const unsigned gen = old / nloc;
        if (old + 1u == (gen + 1u) * nloc) {
            __builtin_amdgcn_fence(__ATOMIC_RELEASE, "agent");
            asm volatile("s_waitcnt vmcnt(0)" ::: "memory");
            const unsigned og = xb_add(&bar[XB_TOP], 1u);
            const unsigned tg = og / nx;
            if (og + 1u == (tg + 1u) * nx) xb_add(&bar[XB_TOPGEN], 1u);
            else XB_SPIN(xb_ld(&bar[XB_TOPGEN]) == tg, bar);
            __builtin_amdgcn_fence(__ATOMIC_ACQUIRE, "agent");
            xb_add(&bar[XB_XGEN(b.x)], 1u);
            asm volatile("s_waitcnt vmcnt(0)" ::: "memory");
        } else {
            XB_SPIN(xb_ld(&bar[XB_XGEN(b.x)]) == gen, bar);
            __builtin_amdgcn_fence(__ATOMIC_ACQUIRE, "agent");
            asm volatile("s_waitcnt vmcnt(0)" ::: "memory");
        }
    }
    __syncthreads();
}

template <int MODE> __device__ __forceinline__ int rowmap(int n) {
    if (MODE == 1) { if (n < 384) return n; const int i = n - 384; return 384 + (i < 32 ? 2 * i : 2 * (i - 32) + 1); }
    if (MODE == 2) { const int h = n / QHD, c = n % QHD; if (c < QKN) return n; const int i = c - QKN; return h * QHD + QKN + (i < 32 ? 2 * i : 2 * (i - 32) + 1); }
    return n;
}
template <int MODE> __device__ __forceinline__ void transpose_item(const float* W, int K, int N, bf16_t* WT, LAS float* scr, int item, int lane) {
    const int nblk = N / 32, kb = item / nblk, nb = item % nblk, k0 = 64 * kb, n0 = 32 * nb;
#pragma unroll 8
    for (int i = 0; i < 32; ++i) { const int kk = 2 * i + (lane >> 5); scr[kk * 33 + (lane & 31)] = W[(size_t)(k0 + kk) * N + n0 + (lane & 31)]; }
    asm volatile("s_waitcnt lgkmcnt(0)" ::: "memory");
    const int c = lane & 7;
#pragma unroll
    for (int j = 0; j < 4; ++j) { const int n = (lane >> 3) + 8 * j; const LAS float* s = scr + (8 * c) * 33 + n;
        u32x4 o; o.x = cvtpk(s[0 * 33], s[1 * 33]); o.y = cvtpk(s[2 * 33], s[3 * 33]); o.z = cvtpk(s[4 * 33], s[5 * 33]); o.w = cvtpk(s[6 * 33], s[7 * 33]);
        *(u32x4*)(WT + (size_t)rowmap<MODE>(n0 + n) * K + k0 + 8 * c) = o; }
    asm volatile("s_waitcnt lgkmcnt(0)" ::: "memory");
}

namespace att {
constexpr int KROW = 400, VROW = 144, KBUF = 64 * KROW, VBUF = 128 * VROW;
#define MFMA32(a, b, c) __builtin_amdgcn_mfma_f32_32x32x16_bf16((a), (b), (c), 0, 0, 0)
__device__ __forceinline__ bf16x8 pack8(const f32x16& x, const int s) {
    u32x4 p; p.x = cvtpk(x[8 * s + 0], x[8 * s + 1]); p.y = cvtpk(x[8 * s + 2], x[8 * s + 3]); p.z = cvtpk(x[8 * s + 4], x[8 * s + 5]); p.w = cvtpk(x[8 * s + 6], x[8 * s + 7]);
    return __builtin_bit_cast(bf16x8, p);
}
__device__ __forceinline__ void attn_phase(LAS unsigned char* lds, const bf16_t* __restrict__ Q, const bf16_t* __restrict__ KN, const bf16_t* __restrict__ KPE, const bf16_t* __restrict__ VT, bf16_t* __restrict__ O, int G, int bid) {
    const int tid = threadIdx.x, lane = tid & 63, w = tid >> 6, r = lane & 31, hh = lane >> 5;
    const int prow = (r & ~12) | ((r & 4) << 1) | ((r & 8) >> 1);
    const unsigned vo_kn = (unsigned)((tid >> 4) * (NH * QKN) + (tid & 15) * 8) * 2u, vo_kpe = (unsigned)((tid >> 3) * QKR + (tid & 7) * 8) * 2u, vo_vt = (unsigned)((tid >> 3) * SEQ + (tid & 7) * 8) * 2u;
    const unsigned vo_q = (unsigned)((w * 32 + r) * (NH * QHD) + 8 * hh) * 2u, vo_o = (unsigned)((w * 32 + r) * (NH * DV) + 4 * hh) * 2u;
    const unsigned ls_kn = (unsigned)((tid >> 4) * KROW + (tid & 15) * 16), ls_kpe = (unsigned)((tid >> 3) * KROW + 256 + (tid & 7) * 16), ls_vt = (unsigned)(2 * KBUF + (tid >> 3) * VROW + (tid & 7) * 16);
    for (int pu = bid; pu < 256; pu += G) {
        for (int half = 0; half < 2; ++half) {
            const int bh = pu >> 2, qb = half == 0 ? 7 - (pu & 3) : (pu & 3);
            const int b = bh >> 3, h = bh & 7;
            const int q0 = qb * 256 + w * 32, nk = 4 * (qb + 1);
            bf16x8 qf[12];
            { const char* qp = (const char*)Q + ((size_t)(b * SEQ + qb * 256) * (NH * QHD) + h * QHD) * 2;
#pragma unroll
              for (int t = 0; t < 12; ++t) qf[t] = *(const bf16x8*)(qp + vo_q + 32 * t); }
            f32x16 o[4];
#pragma unroll
            for (int d = 0; d < 4; ++d)
#pragma unroll
                for (int i = 0; i < 16; ++i) o[d][i] = 0.f;
            float mrun = -INFINITY, lrun = 0.f;
            u32x4 kreg[3], vreg[2];
            const size_t tok0 = (size_t)b * SEQ;
#define ATT_LOAD(kt) do { \
                const char* kb_ = (const char*)KN + ((tok0 + (size_t)(kt) * 64) * (NH * QKN) + h * QKN) * 2; const char* pb_ = (const char*)KPE + (tok0 + (size_t)(kt) * 64) * QKR * 2; \
                const char* vb_ = (const char*)VT + ((size_t)bh * DV * SEQ + (size_t)(kt) * 64) * 2; \
                kreg[0] = *(const u32x4*)(kb_ + vo_kn); kreg[1] = *(const u32x4*)(kb_ + 32 * NH * QKN * 2 + vo_kn); kreg[2] = *(const u32x4*)(pb_ + vo_kpe); \
                vreg[0] = *(const u32x4*)(vb_ + vo_vt); vreg[1] = *(const u32x4*)(vb_ + 64 * SEQ * 2 + vo_vt); } while (0)
#define ATT_STORE(buf) do { \
                *(LAS u32x4*)(lds + (buf) * KBUF + ls_kn) = kreg[0]; *(LAS u32x4*)(lds + (buf) * KBUF + 32 * KROW + ls_kn) = kreg[1]; *(LAS u32x4*)(lds + (buf) * KBUF + ls_kpe) = kreg[2]; \
                *(LAS u32x4*)(lds + (buf) * VBUF + ls_vt) = vreg[0]; *(LAS u32x4*)(lds + (buf) * VBUF + 64 * VROW + ls_vt) = vreg[1]; } while (0)
            ATT_LOAD(0); ATT_STORE(0);
            __syncthreads();
            for (int kt = 0; kt < nk; ++kt) {
                const int buf = kt & 1;
                if (kt + 1 < nk) ATT_LOAD(kt + 1);
                if (64 * kt <= q0 + 31) {
                    f32x16 s0, s1;
#pragma unroll
                    for (int i = 0; i < 16; ++i) { s0[i] = 0.f; s1[i] = 0.f; }
                    const LAS unsigned char* ka = lds + buf * KBUF + prow * KROW + hh * 16;
#pragma unroll
                    for (int tg = 0; tg < 4; ++tg) {
#pragma unroll
                        for (int t = 3 * tg; t < 3 * tg + 3; ++t) { const bf16x8 a0 = *(const LAS bf16x8*)(ka + t * 32), a1 = *(const LAS bf16x8*)(ka + 32 * KROW + t * 32);
                            s0 = MFMA32(a0, qf[t], s0); s1 = MFMA32(a1, qf[t], s1); }
                        __builtin_amdgcn_sched_barrier(0); }
                    if (64 * kt + 63 > q0) { const int q = q0 + r, kb0 = 64 * kt + 8 * hh;
#pragma unroll
                        for (int i = 0; i < 16; ++i) { const int key = kb0 + 16 * (i >> 3) + (i & 7); if (key > q) s0[i] = -INFINITY; if (key + 32 > q) s1[i] = -INFINITY; } }
                    float mx = s0[0];
#pragma unroll
                    for (int i = 1; i < 16; ++i) mx = fmaxf(mx, s0[i]);
#pragma unroll
                    for (int i = 0; i < 16; ++i) mx = fmaxf(mx, s1[i]);
                    mx = fmaxf(mx, __shfl_xor(mx, 32));
                    const float mn = fmaxf(mrun, mx), alpha = __builtin_amdgcn_exp2f(mrun - mn); mrun = mn;
                    float ps = 0.f;
#pragma unroll
                    for (int i = 0; i < 16; ++i) { s0[i] = __builtin_amdgcn_exp2f(s0[i] - mn); s1[i] = __builtin_amdgcn_exp2f(s1[i] - mn); ps += s0[i] + s1[i]; }
                    lrun = lrun * alpha + ps;
#pragma unroll
                    for (int d = 0; d < 4; ++d)
#pragma unroll
                        for (int i = 0; i < 16; ++i) o[d][i] *= alpha;
                    const LAS unsigned char* va = lds + 2 * KBUF + buf * VBUF + r * VROW + hh * 16;
#pragma unroll
                    for (int kb2 = 0; kb2 < 2; ++kb2)
#pragma unroll
                        for (int st = 0; st < 2; ++st) { const bf16x8 pf = pack8(kb2 ? s1 : s0, st);
#pragma unroll
                            for (int d = 0; d < 4; ++d) { const bf16x8 vf = *(const LAS bf16x8*)(va + d * 32 * VROW + kb2 * 64 + st * 32); o[d] = MFMA32(vf, pf, o[d]); }
                            __builtin_amdgcn_sched_barrier(0); }
                }
                if (kt + 1 < nk) ATT_STORE(buf ^ 1);
                __syncthreads();
            }
            lrun += __shfl_xor(lrun, 32);
            const float inv = 1.0f / lrun;
            bf16_t* op = (bf16_t*)((char*)O + ((size_t)(b * SEQ + qb * 256) * (NH * DV) + h * DV) * 2 + vo_o);
#pragma unroll
            for (int d = 0; d < 4; ++d)
#pragma unroll
                for (int g4 = 0; g4 < 4; ++g4) { f32x4 v = {o[d][4 * g4], o[d][4 * g4 + 1], o[d][4 * g4 + 2], o[d][4 * g4 + 3]}; st_bf4(op + 32 * d + 8 * g4, v * inv); }
#undef ATT_LOAD
#undef ATT_STORE
        }
    }
}
}

struct Args { const void* in[33]; float* out; unsigned char* ws; int ph_lo, ph_hi; };
enum { I_X = 0, I_C, I_POS, I_MLA_WIN, I_MLA_QN, I_MLA_WQB, I_MLA_KVN, I_MLA_WKVB, I_MLA_WO, I_SSM_WIN, I_SSM_LOGDT, I_SSM_ARE, I_SSM_AIM, I_SSM_BRE, I_SSM_BIM,
       I_SSM_CRE, I_SSM_CIM, I_SSM_D, I_SSM_WGLU, I_SSM_BGLU, I_SSM_WOUT, I_W1, I_B1, I_W2, I_B2, I_MODMIX_W, I_MODMIX_B, I_MODFFN_W, I_MODFFN_B, I_LNMIX_G, I_LNMIX_B, I_LNFFN_G, I_LNFFN_B };
constexpr int N_PHASES = 20;

__global__ void __launch_bounds__(NWAVES * 64, 2) mega_fwd(Args args) {
    extern __shared__ __attribute__((aligned(16))) unsigned char lds_raw[];
    LAS unsigned char* lds = (LAS unsigned char*)lds_raw;
    volatile LAS unsigned* MISC = (volatile LAS unsigned*)(lds + MISC_OFF);
    const int tid0 = threadIdx.x;
    const int G = gridDim.x, bid = blockIdx.x;
    const int NGW = G * NWAVES, NGT = G * NWAVES * 64;
    unsigned char* ws = args.ws;
    unsigned* ctl = (unsigned*)(ws + WS_CTL);
    const float* x_in = (const float*)args.in[I_X];
    float* R = args.out;
#define WSL unsigned char* wsl = ws; asm volatile("" : "+s"(wsl)); int tid = tid0; asm volatile("" : "+v"(tid)); const int lane = tid & 63, wave = __builtin_amdgcn_readfirstlane(tid >> 6); \
            const int gw = bid * NWAVES + wave, gt = bid * (NWAVES * 64) + tid; (void)lane; (void)gw; (void)gt
#define MOD ((float*)(wsl + CTL_MOD))
#define XN ((bf16_t*)(wsl + WS_XN))
#define OB XN
#define ZB XN
#define Win_t ((bf16_t*)(wsl + WS_WIN))
#define Wqb_t ((bf16_t*)(wsl + WS_WQB))
#define Wkvb_t ((bf16_t*)(wsl + WS_WKVB))
#define Wo_t ((bf16_t*)(wsl + WS_WO))
#define Wsin_t ((bf16_t*)(wsl + WS_WSIN))
#define Wglu_t ((bf16_t*)(wsl + WS_WGLU))
#define Wsout_t ((bf16_t*)(wsl + WS_WSOUT))
#define W1_t ((bf16_t*)(wsl + WS_W1))
#define W2_t ((bf16_t*)(wsl + WS_W2))
#define Bt1 ((bf16_t*)(wsl + WS_BT1))
#define Bt2 ((bf16_t*)(wsl + WS_BT2))
#define ROPE ((float*)(wsl + WS_ROPE))
#define APOW ((float*)(wsl + WS_APOW))
#define BB ((float*)(wsl + WS_BB))
#define KMAT ((float*)(wsl + WS_KMAT))
#define CQ ((bf16_t*)(wsl + WS_CQ))
#define CKV ((bf16_t*)(wsl + WS_CKV))
#define KPE ((bf16_t*)(wsl + WS_KPE))
#define QB ((bf16_t*)(wsl + WS_Q))
#define KN ((bf16_t*)(wsl + WS_KN))
#define VT ((bf16_t*)(wsl + WS_VT))
#define HB ((bf16_t*)(wsl + WS_H))
#define UGH ((bf16_t*)(wsl + WS_UGH))
#define SB ((float*)(wsl + WS_S))
#define GB ((bf16_t*)(wsl + WS_G))

    for (int u = tid0; u < (LDS_BYTES - 131072) / 4; u += NWAVES * 64) ((LAS unsigned*)(lds + 131072))[u] = 0u;
    __syncthreads();
    const int lo = args.ph_lo, hi = args.ph_hi;
    XcdBarrier bar; bar.bar = ctl + 4096; bar.x = 0; bar.st = nullptr;
#if !MK_PER_PHASE && !MK_CG_SYNC
    bar = xcd_barrier_post(ctl + 4096, MISC + 8);
#endif
#if MK_PER_PHASE
#define SEAM() do { } while (0)
#elif MK_CG_SYNC
#define SEAM() do { __threadfence(); cg::this_grid().sync(); } while (0)
#else
#define SEAM() do { if (lo < 0) cg::this_grid().sync(); xcd_barrier(bar); } while (0)
#endif
#ifndef PH_MASK
#define PH_MASK 0xFFFFFu
#endif
#define IN(k) (((PH_MASK >> (k)) & 1u) && lo <= (k) && (k) < hi)
#define END_PHASE(k) do { if (IN((k) + 1)) SEAM(); } while (0)

    if (IN(0)) { WSL;
        LAS float* scr = (LAS float*)(lds + wave * 16384);
        constexpr int I_IN = 16 * 14, I_QB = 4 * 48, I_KVB = 2 * 64, I_SQ = 16 * 32, I_F1 = 16 * 128, I_F2 = 64 * 32;
        constexpr int NIT = I_IN + I_QB + I_KVB + 4 * I_SQ + 2 * I_F1 + 2 * I_F2;
        for (int it = gw; it < NIT; it += NGW) {
            int q = it;
            if (q < I_IN) { transpose_item<1>((const float*)args.in[I_MLA_WIN], D, 448, Win_t, scr, q, lane); continue; } q -= I_IN;
            if (q < I_QB) { transpose_item<2>((const float*)args.in[I_MLA_WQB], QL, NH * QHD, Wqb_t, scr, q, lane); continue; } q -= I_QB;
            if (q < I_KVB) { transpose_item<0>((const float*)args.in[I_MLA_WKVB], KVL, NH * (QKN + DV), Wkvb_t, scr, q, lane); continue; } q -= I_KVB;
            if (q < I_SQ) { transpose_item<0>((const float*)args.in[I_MLA_WO], D, D, Wo_t, scr, q, lane); continue; } q -= I_SQ;
            if (q < I_SQ) { transpose_item<0>((const float*)args.in[I_SSM_WIN], D, D, Wsin_t, scr, q, lane); continue; } q -= I_SQ;
            if (q < I_SQ) { transpose_item<0>((const float*)args.in[I_SSM_WGLU], D, D, Wglu_t, scr, q, lane); continue; } q -= I_SQ;
            if (q < I_SQ) { transpose_item<0>((const float*)args.in[I_SSM_WOUT], D, D, Wsout_t, scr, q, lane); continue; } q -= I_SQ;
            if (q < 2 * I_F1) { const int l = q / I_F1; transpose_item<0>((const float*)args.in[I_W1] + (size_t)l * D * FF, D, FF, W1_t + (size_t)l * D * FF, scr, q % I_F1, lane); continue; } q -= 2 * I_F1;
            { const int l = q / I_F2; transpose_item<0>((const float*)args.in[I_W2] + (size_t)l * D * FF, FF, D, W2_t + (size_t)l * D * FF, scr, q % I_F2, lane); }
        }
        for (int i = gt; i < 64 * D / 8; i += NGT) *(u32x4*)(Win_t + (size_t)448 * D + (size_t)i * 8) = (u32x4){0u, 0u, 0u, 0u};
        {
            const float* cvec = (const float*)args.in[I_C];
            for (int it = NGW - 1 - gw; it < 4 * 48 * 16; it += NGW) {
                const int mi = it / (48 * 16), rem = it % (48 * 16), cb = rem / 16, kc = rem % 16;
                const float* Wm = (const float*)args.in[(mi & 1) ? I_MODFFN_W : I_MODMIX_W] + (size_t)(mi >> 1) * D * 3 * D;
                const float* bm = (const float*)args.in[(mi & 1) ? I_MODFFN_B : I_MODMIX_B] + (size_t)(mi >> 1) * 3 * D;
                float csv[8], accv[8];
#pragma unroll
                for (int b = 0; b < 8; ++b) { const float cv = cvec[b * D + kc * 64 + lane]; csv[b] = cv / (1.0f + __expf(-cv)); accv[b] = 0.f; }
                const float* wp = Wm + (size_t)(kc * 64) * 3 * D + cb * 64 + lane;
#pragma unroll 8
                for (int k = 0; k < 64; ++k) { const float wv = wp[(size_t)k * 3 * D];
#pragma unroll
                    for (int b = 0; b < 8; ++b) accv[b] += __shfl(csv[b], k) * wv; }
                const float bias = (kc == 0) ? bm[cb * 64 + lane] : 0.f;
#pragma unroll
                for (int b = 0; b < 8; ++b) atomicAdd(MOD + ((size_t)(mi * 8 + b)) * 3 * D + cb * 64 + lane, accv[b] + bias);
            }
        }
        {
            const int* pos = (const int*)args.in[I_POS];
            for (int i = gt; i < M * 32; i += NGT) { const int row = i >> 5, j = i & 31;
                const float inv = exp2f(-(float)j * (13.287712379549449f / 32.0f));
                const float ang = (float)pos[row] * inv; float sn, cs; sincosf(ang, &sn, &cs);
                *(f32x2*)(ROPE + (size_t)i * 2) = (f32x2){cs, sn}; }
        }
        for (int i = gt; i < NG * NS; i += NGT) { const int g = i >> 6, p = i & 63;
            const double dt = exp((double)((const float*)args.in[I_SSM_LOGDT])[g]);
            const double lr = (double)((const float*)args.in[I_SSM_ARE])[i], li = (double)((const float*)args.in[I_SSM_AIM])[i];
            double abr = 1.0, abi = 0.0;
            for (int j = 0; j <= 16; ++j) { const double mag = exp(lr * dt * j), ang = li * dt * j; const double cr = mag * cos(ang), ci = mag * sin(ang);
                if (j == 1) { abr = cr; abi = ci; }
                *(f32x2*)(APOW + ((size_t)(g * 17 + j) * 64 + p) * 2) = (f32x2){(float)cr, (float)ci}; }
            const double den = lr * lr + li * li, nr = abr - 1.0;
            const double cre = (nr * lr + abi * li) / den, cim = (abi * lr - nr * li) / den;
            const float* bre = (const float*)args.in[I_SSM_BRE] + (size_t)i * 16; const float* bim = (const float*)args.in[I_SSM_BIM] + (size_t)i * 16;
            for (int c = 0; c < 16; ++c) { const double br = bre[c], bi = bim[c];
                *(f32x2*)(BB + ((size_t)i * 16 + c) * 2) = (f32x2){(float)(cre * br - cim * bi), (float)(cre * bi + cim * br)}; } }
        END_PHASE(0);
    }

    if (IN(1)) { WSL;
        for (int row = gw; row < M; row += NGW) { const int b = row >> 11; const float* mp = MOD + (size_t)(0 * 8 + b) * 3 * D;
#pragma unroll
            for (int j = 0; j < 4; ++j) { const int col = 4 * lane + 256 * j; const f32x4 v = *(const f32x4*)(x_in + (size_t)row * D + col), sh = *(const f32x4*)(mp + col), sc = *(const f32x4*)(mp + D + col);
                st_bf4(XN + (size_t)row * D + col, v * (sc + 1.0f) + sh); } }
        const float* cre = (const float*)args.in[I_SSM_CRE]; const float* cim = (const float*)args.in[I_SSM_CIM]; const float* dsk = (const float*)args.in[I_SSM_D];
        for (int i = gt; i < NG * 16 * 256; i += NGT) { const int g = i >> 12, j = (i >> 8) & 15, c = (i >> 4) & 15, c2 = i & 15;
            float s = 0.f;
            for (int p = 0; p < 64; ++p) { const f32x2 ap = *(const f32x2*)(APOW + ((size_t)(g * 17 + j) * 64 + p) * 2), bb = *(const f32x2*)(BB + ((size_t)((g * 64 + p) * 16 + c2)) * 2);
                const float tr = ap.x * bb.x - ap.y * bb.y, ti = ap.x * bb.y + ap.y * bb.x; s += cre[(g * 16 + c) * 64 + p] * tr - cim[(g * 16 + c) * 64 + p] * ti; }
            if (j == 0 && c == c2) s += dsk[g * 16 + c];
            KMAT[i] = s; }
        for (int i = gt; i < NG * 256 * 16; i += NGT) { const int g = i >> 12, n = (i >> 4) & 255, s = i & 15;
            u32x4 o0 = {0u, 0u, 0u, 0u}, o1 = {0u, 0u, 0u, 0u};
            if (n < 128) { const int p = n & 63, im = n >> 6; const f32x2 ap = *(const f32x2*)(APOW + ((size_t)(g * 17 + (15 - s)) * 64 + p) * 2); float v[16];
#pragma unroll
                for (int c = 0; c < 16; ++c) { const f32x2 bb = *(const f32x2*)(BB + ((size_t)((g * 64 + p) * 16 + c)) * 2); v[c] = im ? (ap.x * bb.y + ap.y * bb.x) : (ap.x * bb.x - ap.y * bb.y); }
                o0 = (u32x4){cvtpk(v[0], v[1]), cvtpk(v[2], v[3]), cvtpk(v[4], v[5]), cvtpk(v[6], v[7])}; o1 = (u32x4){cvtpk(v[8], v[9]), cvtpk(v[10], v[11]), cvtpk(v[12], v[13]), cvtpk(v[14], v[15])}; }
            bf16_t* dst = Bt1 + ((size_t)(g * 256 + n)) * 256 + s * 16; *(u32x4*)dst = o0; *(u32x4*)(dst + 8) = o1; }
        END_PHASE(1);
    }

    if (IN(2)) { WSL;
        pg8::Gemm g{XN, Win_t, D, D, D}; pg8::StaticOrder S; S.init(M, 512, G, bid);
        pg8::EpiMlaIn E{CQ, CKV, KPE, (const float*)args.in[I_MLA_QN], (const float*)args.in[I_MLA_KVN], ROPE};
        pg8::gemm_phase<pg8::EpiMlaIn, pg8::StaticOrder, false>(lds, g, S, E);
        END_PHASE(2);
    }
    if (IN(3)) { WSL;
        { pg8::Gemm g{CQ, Wqb_t, QL, QL, QL}; pg8::StaticOrder S; S.init(M, NH * QHD, G, bid);
          pg8::EpiEl<FQ> E{FQ{QB, ROPE}}; pg8::gemm_phase<pg8::EpiEl<FQ>, pg8::StaticOrder, true>(lds, g, S, E); }
        { pg8::Gemm g{CKV, Wkvb_t, KVL, KVL, KVL}; pg8::StaticOrder S; S.init(M, NH * (QKN + DV), G, bid);
          pg8::EpiEl<FKV> E{FKV{KN, VT}}; pg8::gemm_phase<pg8::EpiEl<FKV>, pg8::StaticOrder, true>(lds, g, S, E); }
        END_PHASE(3);
    }
    if (IN(4)) { WSL;
        att::attn_phase(lds, QB, KN, KPE, VT, OB, G, bid);
        END_PHASE(4);
    }
    if (IN(5)) { WSL;
        pg8::Gemm g{OB, Wo_t, D, D, D}; pg8::StaticOrder S; S.init(M, D, G, bid);
        pg8::EpiEl<FRes> E{FRes{x_in, R, MOD + (size_t)0 * 8 * 3 * D + 2 * D, nullptr}};
        pg8::gemm_phase<pg8::EpiEl<FRes>, pg8::StaticOrder, true>(lds, g, S, E);
        END_PHASE(5);
    }
#define LN_PASS(lg, lb, modnext, do_xn) do { \
        for (int row = gw; row < M; row += NGW) { const int b = row >> 11; float* rp = R + (size_t)row * D; f32x4 v[4]; float s = 0.f; \
            _Pragma("unroll") for (int j = 0; j < 4; ++j) { v[j] = *(const f32x4*)(rp + 4 * lane + 256 * j); s += (v[j].x + v[j].y) + (v[j].z + v[j].w); } \
            const float mean = wave_sum(s) * (1.0f / D); float s2 = 0.f; \
            _Pragma("unroll") for (int j = 0; j < 4; ++j) { v[j] = v[j] - mean; s2 += (v[j].x * v[j].x + v[j].y * v[j].y) + (v[j].z * v[j].z + v[j].w * v[j].w); } \
            const float rstd = 1.0f / sqrtf(wave_sum(s2) * (1.0f / D) + LN_EPS); \
            _Pragma("unroll") for (int j = 0; j < 4; ++j) { const int col = 4 * lane + 256 * j; const f32x4 y = v[j] * rstd * *(const f32x4*)((lg) + col) + *(const f32x4*)((lb) + col); \
                *(f32x4*)(rp + col) = y; \
                if (do_xn) { const float* mp = (modnext) + (size_t)b * 3 * D; st_bf4(XN + (size_t)row * D + col, y * (*(const f32x4*)(mp + D + col) + 1.0f) + *(const f32x4*)(mp + col)); } } } } while (0)
    if (IN(6)) { WSL;
        LN_PASS((const float*)args.in[I_LNMIX_G], (const float*)args.in[I_LNMIX_B], MOD + (size_t)1 * 8 * 3 * D, true);
        const float* cre = (const float*)args.in[I_SSM_CRE]; const float* cim = (const float*)args.in[I_SSM_CIM];
        for (int i = gt; i < NG * 256 * 24; i += NGT) { const int q = i % 24, gn = i / 24, g = gn >> 8, n = gn & 255, t = n >> 4, c = n & 15; float v[16];
            if (q < 16) { if (q <= t) { const float* km = KMAT + (((size_t)(g * 16 + (t - q)) * 16 + c) * 16);
#pragma unroll
                    for (int e = 0; e < 16; ++e) v[e] = km[e]; } else {
#pragma unroll
                    for (int e = 0; e < 16; ++e) v[e] = 0.f; } }
            else { const int im = q >= 20, p0 = ((q - 16) & 3) * 16;
#pragma unroll
                for (int e = 0; e < 16; ++e) { const int p = p0 + e; const f32x2 ap = *(const f32x2*)(APOW + ((size_t)(g * 17 + t + 1) * 64 + p) * 2); const float cr = cre[(g * 16 + c) * 64 + p], ci = cim[(g * 16 + c) * 64 + p];
                    v[e] = im ? -(cr * ap.y + ci * ap.x) : (cr * ap.x - ci * ap.y); } }
            bf16_t* dst = Bt2 + (size_t)gn * 384 + q * 16;
            *(u32x4*)dst = (u32x4){cvtpk(v[0], v[1]), cvtpk(v[2], v[3]), cvtpk(v[4], v[5]), cvtpk(v[6], v[7])}; *(u32x4*)(dst + 8) = (u32x4){cvtpk(v[8], v[9]), cvtpk(v[10], v[11]), cvtpk(v[12], v[13]), cvtpk(v[14], v[15])}; }
        END_PHASE(6);
    }
    if (IN(7)) { WSL;
        pg8::Gemm g{XN, W1_t, D, D, D}; pg8::StaticOrder S; S.init(M, FF, G, bid);
        pg8::EpiEl<FRelu2> E{FRelu2{HB, (const float*)args.in[I_B1]}};
        pg8::gemm_phase<pg8::EpiEl<FRelu2>, pg8::StaticOrder, true>(lds, g, S, E);
        END_PHASE(7);
    }
    if (IN(8)) { WSL;
        pg8::Gemm g{HB, W2_t, FF, FF, FF}; pg8::StaticOrder S; S.init(M, D, G, bid);
        pg8::EpiEl<FRes> E{FRes{R, R, MOD + (size_t)1 * 8 * 3 * D + 2 * D, (const float*)args.in[I_B2]}};
        pg8::gemm_phase<pg8::EpiEl<FRes>, pg8::StaticOrder, true>(lds, g, S, E);
        END_PHASE(8);
    }
    if (IN(9)) { WSL; LN_PASS((const float*)args.in[I_LNFFN_G], (const float*)args.in[I_LNFFN_B], MOD + (size_t)2 * 8 * 3 * D, true); END_PHASE(9); }
    if (IN(10)) { WSL;
        pg8::Gemm g{XN, Wsin_t, D, D, D}; pg8::StaticOrder S; S.init(M, D, G, bid);
        pg8::EpiEl<FU> E{FU{UGH}}; pg8::gemm_phase<pg8::EpiEl<FU>, pg8::StaticOrder, true>(lds, g, S, E);
        END_PHASE(10);
    }
    if (IN(11)) { WSL;
        pg8::Gemm g{UGH, Bt1, 256, 384, 256}; pg8::GroupOrder S{G, bid};
        pg8::EpiEl<FS> E{FS{SB}}; pg8::gemm_phase<pg8::EpiEl<FS>, pg8::GroupOrder, true>(lds, g, S, E);
        END_PHASE(11);
    }
    if (IN(12)) { WSL;
        for (int it = gw; it < NG * BATCH; it += NGW) { const int g = it >> 3;
            const f32x2 aT = *(const f32x2*)(APOW + ((size_t)(g * 17 + 16) * 64 + lane) * 2);
            float hr = 0.f, hi_ = 0.f; const size_t row0 = (size_t)it * NCH;
#pragma unroll 8
            for (int k = 0; k < NCH; ++k) { const size_t row = row0 + k;
                UGH[row * 384 + 256 + lane] = (bf16_t)(cvtpk(hr, 0.f) & 0xffffu); UGH[row * 384 + 320 + lane] = (bf16_t)(cvtpk(hi_, 0.f) & 0xffffu);
                const float sr = SB[row * 128 + lane], si = SB[row * 128 + 64 + lane];
                const float nr = aT.x * hr - aT.y * hi_ + sr, ni = aT.x * hi_ + aT.y * hr + si; hr = nr; hi_ = ni; } }
        END_PHASE(12);
    }
    if (IN(13)) { WSL;
        pg8::Gemm g{UGH, Bt2, 384, 384, 384}; pg8::GroupOrder S{G, bid};
        pg8::EpiEl<FG> E{FG{GB}}; pg8::gemm_phase<pg8::EpiEl<FG>, pg8::GroupOrder, true>(lds, g, S, E);
        END_PHASE(13);
    }
    if (IN(14)) { WSL;
        pg8::Gemm g{GB, Wglu_t, D, D, D}; pg8::StaticOrder S; S.init(M, D, G, bid);
        pg8::EpiEl<FGlu> E{FGlu{GB, ZB, (const float*)args.in[I_SSM_BGLU]}}; pg8::gemm_phase<pg8::EpiEl<FGlu>, pg8::StaticOrder, true>(lds, g, S, E);
        END_PHASE(14);
    }
    if (IN(15)) { WSL;
        pg8::Gemm g{ZB, Wsout_t, D, D, D}; pg8::StaticOrder S; S.init(M, D, G, bid);
        pg8::EpiEl<FRes> E{FRes{R, R, MOD + (size_t)2 * 8 * 3 * D + 2 * D, nullptr}};
        pg8::gemm_phase<pg8::EpiEl<FRes>, pg8::StaticOrder, true>(lds, g, S, E);
        END_PHASE(15);
    }
    if (IN(16)) { WSL; LN_PASS((const float*)args.in[I_LNMIX_G] + D, (const float*)args.in[I_LNMIX_B] + D, MOD + (size_t)3 * 8 * 3 * D, true); END_PHASE(16); }
    if (IN(17)) { WSL;
        pg8::Gemm g{XN, W1_t + (size_t)D * FF, D, D, D}; pg8::StaticOrder S; S.init(M, FF, G, bid);
        pg8::EpiEl<FRelu2> E{FRelu2{HB, (const float*)args.in[I_B1] + FF}};
        pg8::gemm_phase<pg8::EpiEl<FRelu2>, pg8::StaticOrder, true>(lds, g, S, E);
        END_PHASE(17);
    }
    if (IN(18)) { WSL;
        pg8::Gemm g{HB, W2_t + (size_t)D * FF, FF, FF, FF}; pg8::StaticOrder S; S.init(M, D, G, bid);
        pg8::EpiEl<FRes> E{FRes{R, R, MOD + (size_t)3 * 8 * 3 * D + 2 * D, (const float*)args.in[I_B2] + D}};
        pg8::gemm_phase<pg8::EpiEl<FRes>, pg8::StaticOrder, true>(lds, g, S, E);
        END_PHASE(18);
    }
    if (IN(19)) { WSL; LN_PASS((const float*)args.in[I_LNFFN_G] + D, (const float*)args.in[I_LNFFN_B] + D, MOD, false); }
}

extern "C" void kernel_launch(void* const* d_in, const int* in_sizes, int n_in, void* d_out, int out_size, void* d_ws, size_t ws_size, hipStream_t stream) {
    static int grid = 0;
    if (grid == 0) {
        if (n_in != 33 || out_size != M * D || ws_size < WS_END) { fprintf(stderr, "kernel_launch: unexpected problem (n_in %d out %d ws %zu)\n", n_in, out_size, ws_size); grid = -1; return; }
        int dev = 0, cus = 0, per_cu = 0;
        if (hipGetDevice(&dev) != hipSuccess || hipDeviceGetAttribute(&cus, hipDeviceAttributeMultiprocessorCount, dev) != hipSuccess) { grid = -1; return; }
        if (hipFuncSetAttribute((const void*)mega_fwd, hipFuncAttributeMaxDynamicSharedMemorySize, LDS_BYTES) != hipSuccess) { fprintf(stderr, "kernel_launch: hipFuncSetAttribute failed\n"); grid = -1; return; }
        if (hipOccupancyMaxActiveBlocksPerMultiprocessor(&per_cu, (const void*)mega_fwd, NWAVES * 64, LDS_BYTES) != hipSuccess || per_cu < 1) { fprintf(stderr, "kernel_launch: occupancy query says %d\n", per_cu); per_cu = 1; }
        (void)hipGetLastError();
        grid = cus * 1;
    }
    if (grid < 0) return;
    (void)hipMemsetAsync((char*)d_ws + WS_CTL, 0, CTL_ZERO_BYTES, stream);
    Args a{};
    for (int i = 0; i < 33; ++i) a.in[i] = d_in[i];
    a.out = (float*)d_out; a.ws = (unsigned char*)d_ws;
#if MK_PER_PHASE
    for (int p = 0; p < N_PHASES; ++p) { a.ph_lo = p; a.ph_hi = p + 1; hipLaunchKernelGGL(mega_fwd, dim3(grid), dim3(NWAVES * 64), LDS_BYTES, stream, a); }
#else
    a.ph_lo = 0; a.ph_hi = N_PHASES;
    void* kargs[] = {&a};
    hipError_t e = hipLaunchCooperativeKernel((const void*)mega_fwd, dim3(grid), dim3(NWAVES * 64), kargs, LDS_BYTES, stream);
    if (e != hipSuccess) fprintf(stderr, "kernel_launch: cooperative launch failed: %s (grid %d)\n", hipGetErrorString(e), grid);
#endif
}
```
